# Optimizing an MI355X kernel written in HIP

```python
import jax, jax.numpy as jnp
from jax import lax
import numpy as np

D_MODEL = 1024
BATCH = 2
SEQ = 8192
DEPTH = 2
DEC_BATCH = 128
DEC_SEQ = 4
PAST_LEN = 16384
PAGE_SIZE = 128

N_META = 16
D_CONV = D_MODEL // 2
CONV_W = 3
HEAD_DIM = 64
N_HEADS = (D_MODEL // 2) // HEAD_DIM
N_KV = 2
GROUP = N_HEADS // N_KV
WINDOW = 128
BLOCK = 128
Q_DIM = N_HEADS * HEAD_DIM
KV_DIM = N_KV * HEAD_DIM
POOL_WINDOWS = (2, 4, 8, 16)
N_POOL_GROUPS = len(POOL_WINDOWS)
POOL_GROUP_DIM = D_MODEL // N_POOL_GROUPS
POOL_MAX = 16
D_FF = 4 * D_MODEL
EPS = 1e-6
NEG = -1e30
N_EVEN = (DEPTH + 1) // 2
N_ODD = DEPTH // 2
D_IN_EVEN = 3 * D_CONV + Q_DIM + 2 * KV_DIM
D_MIX_EVEN = D_CONV + Q_DIM
SPLITS = (D_CONV, 2 * D_CONV, 3 * D_CONV, 3 * D_CONV + Q_DIM, 3 * D_CONV + Q_DIM + KV_DIM)

kernel_name = 'hybrid_conv_swa_pool_decoder'


def rmsnorm(x, g):
    xf = x.astype(jnp.float32)
    y = xf * lax.rsqrt(jnp.mean(xf * xf, axis=-1, keepdims=True) + EPS)
    return (y * g.astype(jnp.float32)).astype(x.dtype)


def short_conv(xa, gc, gb, buf, conv_w):
    u = gc * xa
    ue = jnp.concatenate([buf.astype(u.dtype), u], axis=1)
    T = u.shape[1]
    y = ue[:, 0:T] * conv_w[0]
    for j in range(1, CONV_W):
        y = y + ue[:, j:j + T] * conv_w[j]
    return gb * y, ue[:, -(CONV_W - 1):]


def sink_softmax_weights(s, sk, dtype):
    m = jnp.maximum(jnp.max(s, axis=-1, keepdims=True), sk)
    p = jnp.exp(s - m)
    denom = jnp.sum(p, axis=-1, keepdims=True) + jnp.exp(sk - m)
    return (p / denom).astype(dtype)


def swa_prompt(q, k, v, sinks):
    B, L = q.shape[:2]
    pad_front = (-N_META) % BLOCK
    lp0 = pad_front + L
    pad_back = (-lp0) % BLOCK
    lp = lp0 + pad_back
    nb = lp // BLOCK
    qp = jnp.pad(q, ((0, 0), (pad_front, pad_back), (0, 0), (0, 0)))
    qp = qp.reshape(B, nb, BLOCK, N_KV, GROUP, HEAD_DIM)
    kvpad = ((0, 0), (pad_front + BLOCK, pad_back), (0, 0), (0, 0))
    kp = jnp.pad(k, kvpad).reshape(B, nb + 1, BLOCK, N_KV, HEAD_DIM)
    vp = jnp.pad(v, kvpad).reshape(B, nb + 1, BLOCK, N_KV, HEAD_DIM)
    kb = jnp.concatenate([kp[:, :-1], kp[:, 1:]], axis=2)
    vb = jnp.concatenate([vp[:, :-1], vp[:, 1:]], axis=2)
    s = jnp.einsum('bnqkgd,bnskd->bnkgqs', qp, kb, preferred_element_type=jnp.float32) * (HEAD_DIM ** -0.5)
    qi = jnp.arange(nb)[:, None] * BLOCK + jnp.arange(BLOCK)[None, :]
    kj = jnp.arange(nb)[:, None] * BLOCK - BLOCK + jnp.arange(2 * BLOCK)[None, :]
    d = qi[:, :, None] - kj[:, None, :]
    valid = (d >= 0) & (d <= WINDOW) & (kj[:, None, :] >= pad_front)
    s = jnp.where(valid[None, :, None, None], s, NEG)
    sk = sinks.astype(jnp.float32).reshape(N_KV, GROUP)[None, None, :, :, None, None]
    p = sink_softmax_weights(s, sk, v.dtype)
    o = jnp.einsum('bnkgqs,bnskd->bnqkgd', p, vb)
    return o.reshape(B, lp, Q_DIM)[:, pad_front:pad_front + L]


def swa_sample(q, k, v, ck, cv, sinks):
    Bd, T = q.shape[:2]
    wb = ck.shape[1]
    ke = jnp.concatenate([ck.astype(k.dtype), k], axis=1)
    ve = jnp.concatenate([cv.astype(v.dtype), v], axis=1)
    qg = q.reshape(Bd, T, N_KV, GROUP, HEAD_DIM)
    s = jnp.einsum('btkgd,bskd->bkgts', qg, ke, preferred_element_type=jnp.float32) * (HEAD_DIM ** -0.5)
    d = (wb + jnp.arange(T))[:, None] - jnp.arange(wb + T)[None, :]
    valid = (d >= 0) & (d <= WINDOW)
    s = jnp.where(valid[None, None, None], s, NEG)
    sk = sinks.astype(jnp.float32).reshape(N_KV, GROUP)[None, :, :, None, None]
    p = sink_softmax_weights(s, sk, v.dtype)
    o = jnp.einsum('bkgts,bskd->btkgd', p, ve).reshape(Bd, T, Q_DIM)
    return o, ke[:, -wb:], ve[:, -wb:]


def pool_mix(h, buf, pos0, w_pool, scale):
    B, T, D = h.shape
    P = POOL_MAX - 1
    he = jnp.concatenate([buf.astype(h.dtype), h], axis=1)
    cs = jnp.cumsum(he.astype(jnp.float32), axis=1)
    cs = jnp.pad(cs, ((0, 0), (1, 0), (0, 0)))
    end = cs[:, P + 1:]
    pos = pos0 + jnp.arange(T)
    groups = []
    for gi, w in enumerate(POOL_WINDOWS):
        sl = slice(gi * POOL_GROUP_DIM, (gi + 1) * POOL_GROUP_DIM)
        start = cs[:, P + 1 - w:P + 1 - w + T, sl]
        cnt = jnp.minimum(w, pos + 1).astype(jnp.float32)[None, :, None]
        groups.append((end[..., sl] - start) / cnt)
    pooled = jnp.concatenate(groups, axis=-1)
    dlt = (pooled - h.astype(jnp.float32)).astype(h.dtype).reshape(B, T, N_POOL_GROUPS, POOL_GROUP_DIM)
    y = jnp.einsum('btgc,gce->btge', dlt, w_pool).reshape(B, T, D)
    return y * scale, he[:, -P:]


def sqrelu_mlp(x, w_up, w_down):
    return jnp.square(jax.nn.relu(x @ w_up)) @ w_down


def trunk(x, pos0, conv_st, k_st, v_st, pool_st, is_prompt, norm_mix, norm_mlp, w_in_even, conv_w,
          q_norm, k_norm, attn_sinks, w_out_even, w_pool, pool_scale, w_up, w_down):
    B, T, _ = x.shape
    conv_new, k_new, v_new, pool_new = [], [], [], []
    for layer in range(DEPTH):
        i = layer // 2
        h = rmsnorm(x, norm_mix[layer])
        if layer % 2 == 0:
            z = h @ w_in_even[i]
            xa, gc, gb, q, k, v = jnp.split(z, SPLITS, axis=-1)
            ya, cbuf = short_conv(xa, gc, gb, conv_st[i], conv_w[i])
            q = rmsnorm(q.reshape(B, T, N_HEADS, HEAD_DIM), q_norm[i])
            k = rmsnorm(k.reshape(B, T, N_KV, HEAD_DIM), k_norm[i])
            v = v.reshape(B, T, N_KV, HEAD_DIM)
            if is_prompt:
                yb = swa_prompt(q, k, v, attn_sinks[i])
                kbuf, vbuf = k[:, -WINDOW:], v[:, -WINDOW:]
            else:
                yb, kbuf, vbuf = swa_sample(q, k, v, k_st[i], v_st[i], attn_sinks[i])
            x = x + jnp.concatenate([ya, yb], axis=-1) @ w_out_even[i]
            conv_new.append(cbuf)
            k_new.append(kbuf)
            v_new.append(vbuf)
        else:
            yc, pbuf = pool_mix(h, pool_st[i], pos0, w_pool[i], pool_scale[i])
            x = x + yc
            pool_new.append(pbuf)
        x = x + sqrelu_mlp(rmsnorm(x, norm_mlp[layer]), w_up[layer], w_down[layer])
    return x, jnp.stack(conv_new), jnp.stack(k_new), jnp.stack(v_new), jnp.stack(pool_new)


def setup_inputs(seed: int = 0) -> dict:
    key = jax.random.key(seed)
    ks = jax.random.split(key, 20)
    f32 = jnp.float32

    def nrm(k, shape, scale):
        return jax.random.normal(k, shape, f32) * scale

    win_rows = min(WINDOW, PAST_LEN)
    return {
        'x_prompt': nrm(ks[0], (BATCH, SEQ, D_MODEL), 1.0),
        'x_sample': nrm(ks[1], (DEC_BATCH, DEC_SEQ, D_MODEL), 1.0),
        'state_conv': nrm(ks[2], (N_EVEN, DEC_BATCH, CONV_W - 1, D_CONV), 1.0),
        'cache_k_win': nrm(ks[3], (N_EVEN, DEC_BATCH, win_rows, N_KV, HEAD_DIM), 1.0),
        'cache_v_win': nrm(ks[4], (N_EVEN, DEC_BATCH, win_rows, N_KV, HEAD_DIM), 1.0),
        'state_pool': nrm(ks[5], (N_ODD, DEC_BATCH, POOL_MAX - 1, D_MODEL), 1.0),
        'meta_tokens': nrm(ks[6], (N_META, D_MODEL), 1.0),
        'norm_mix': 1.0 + nrm(ks[7], (DEPTH, D_MODEL), 0.02),
        'norm_mlp': 1.0 + nrm(ks[8], (DEPTH, D_MODEL), 0.02),
        'w_in_even': nrm(ks[9], (N_EVEN, D_MODEL, D_IN_EVEN), D_MODEL ** -0.5),
        'conv_w': nrm(ks[10], (N_EVEN, CONV_W, D_CONV), CONV_W ** -0.5),
        'q_norm': 1.0 + nrm(ks[11], (N_EVEN, HEAD_DIM), 0.02),
        'k_norm': 1.0 + nrm(ks[12], (N_EVEN, HEAD_DIM), 0.02),
        'attn_sinks': nrm(ks[13], (N_EVEN, N_HEADS), 0.5),
        'w_out_even': nrm(ks[14], (N_EVEN, D_MIX_EVEN, D_MODEL), D_MIX_EVEN ** -0.5),
        'w_pool': nrm(ks[15], (N_ODD, N_POOL_GROUPS, POOL_GROUP_DIM, POOL_GROUP_DIM), POOL_GROUP_DIM ** -0.5),
        'pool_scale': 1.0 + nrm(ks[16], (N_ODD, D_MODEL), 0.1),
        'w_up': nrm(ks[17], (DEPTH, D_MODEL, D_FF), D_MODEL ** -0.5),
        'w_down': nrm(ks[18], (DEPTH, D_FF, D_MODEL), D_FF ** -0.5),
    }


def reference(x_prompt, x_sample, state_conv, cache_k_win, cache_v_win, state_pool, meta_tokens,
              norm_mix, norm_mlp, w_in_even, conv_w, q_norm, k_norm, attn_sinks, w_out_even,
              w_pool, pool_scale, w_up, w_down):
    weights = (norm_mix, norm_mlp, w_in_even, conv_w, q_norm, k_norm, attn_sinks, w_out_even,
               w_pool, pool_scale, w_up, w_down)
    B = x_prompt.shape[0]
    dt = x_prompt.dtype
    meta = jnp.broadcast_to(meta_tokens.astype(dt)[None], (B, N_META, D_MODEL))
    xp = jnp.concatenate([meta, x_prompt], axis=1)
    zero_conv = jnp.zeros((N_EVEN, B, CONV_W - 1, D_CONV), dt)
    zero_pool = jnp.zeros((N_ODD, B, POOL_MAX - 1, D_MODEL), dt)
    hp, conv_p, k_p, v_p, pool_p = trunk(xp, 0, zero_conv, None, None, zero_pool, True, *weights)
    y_prompt = hp[:, N_META:]
    y_sample, conv_s, k_s, v_s, pool_s = trunk(x_sample, PAST_LEN, state_conv, cache_k_win, cache_v_win,
                                               state_pool, False, *weights)
    return (y_prompt, y_sample, conv_p, conv_s, k_p, k_s, v_p, v_s, pool_p, pool_s)
```

```cpp
#include <hip/hip_runtime.h>
#include <cstdio>
#include <cstdint>

constexpr int D = 1024, FF = 4096, DIN = 2304, DCONV = 512, HD = 64;
constexpr int LP = 8208;
constexpr int MPROMPT = 2 * LP;
constexpr int MSAMP = 512;
constexpr int M = MPROMPT + MSAMP;
constexpr int NPANEL = 67, MPAD = NPANEL * 256;
constexpr float EPS = 1e-6f;
constexpr float LOG2E = 1.4426950408889634f;
constexpr size_t O_YP = 0, O_YS = O_YP + (size_t)2 * 8192 * 1024, O_CONVP = O_YS + (size_t)512 * 1024, O_CONVS = O_CONVP + 2 * 2 * 512,
                 O_KP = O_CONVS + (size_t)128 * 2 * 512, O_KS = O_KP + (size_t)2 * 128 * 128, O_VP = O_KS + (size_t)128 * 128 * 128,
                 O_VS = O_VP + (size_t)2 * 128 * 128, O_POOLP = O_VS + (size_t)128 * 128 * 128, O_POOLS = O_POOLP + (size_t)2 * 15 * 1024,
                 O_END = O_POOLS + (size_t)128 * 15 * 1024;
static_assert(O_END == 23691264, "output size");
constexpr size_t MiB = 1u << 20;
constexpr size_t WS_CTL = 0, CTL_ZERO_BYTES = 1 * MiB;
constexpr size_t WS_WIN = 1 * MiB;
constexpr size_t WS_WOUT = WS_WIN + (size_t)DIN * D * 2;
constexpr size_t WS_WUP0 = WS_WOUT + (size_t)D * D * 2;
constexpr size_t WS_WDN0 = WS_WUP0 + (size_t)FF * D * 2;
constexpr size_t WS_WUP1 = WS_WDN0 + (size_t)FF * D * 2;
constexpr size_t WS_WDN1 = WS_WUP1 + (size_t)FF * D * 2;
constexpr size_t WS_WPOOL = WS_WDN1 + (size_t)FF * D * 2;
constexpr size_t WS_X = 40 * MiB;
constexpr size_t WS_BIG = 107 * MiB;
constexpr size_t WS_H0 = WS_BIG, WS_MIX = WS_BIG, WS_DLT = WS_BIG, WS_Z = WS_BIG + (size_t)MPAD * D * 2, WS_HID = WS_BIG;
constexpr size_t WS_SS = 241 * MiB;
constexpr size_t SS_BYTES = (size_t)MPAD * 16 * 4;
constexpr size_t WS_END = 256 * MiB;
static_assert(WS_WPOOL + 4 * 256 * 256 * 2 <= WS_X && WS_X + (size_t)MPAD * D * 4 <= WS_BIG && WS_Z + (size_t)MPAD * DIN * 2 <= WS_SS && WS_HID + (size_t)MPAD * FF * 2 <= WS_SS && WS_SS + 3 * SS_BYTES <= WS_END, "ws map");

#define GAS __attribute__((address_space(1)))
#define LAS __attribute__((address_space(3)))
typedef unsigned short bf16_t;
typedef short bf16x8 __attribute__((ext_vector_type(8)));
typedef float f32x4 __attribute__((ext_vector_type(4)));
typedef float f32x16 __attribute__((ext_vector_type(16)));
typedef unsigned u32x4 __attribute__((ext_vector_type(4)));
typedef unsigned u32x2 __attribute__((ext_vector_type(2)));
typedef GAS unsigned gu32;

__device__ __forceinline__ unsigned cvt_pk_bf16(float lo, float hi) { unsigned r; asm volatile("v_cvt_pk_bf16_f32 %0, %1, %2" : "=v"(r) : "v"(lo), "v"(hi)); return r; }
__device__ __forceinline__ float bf_lo(unsigned u) { return __uint_as_float(u << 16); }
__device__ __forceinline__ float bf_hi(unsigned u) { return __uint_as_float(u & 0xffff0000u); }
__device__ __forceinline__ float bf1(bf16_t u) { return __uint_as_float(((unsigned)u) << 16); }

struct RowMap { const float* xp; const float* xs; const float* meta; float* yp; float* ys; };
__device__ __forceinline__ const float* in_row(const RowMap& R, int r) {
    if (r < MPROMPT) { const int b = r >= LP ? 1 : 0, t = r - b * LP; return t < 16 ? R.meta + (size_t)t * D : R.xp + ((size_t)(b * 8192 + t - 16)) * D; }
    const int s = r - MPROMPT; return R.xs + (size_t)(s < MSAMP ? s : 0) * D;
}
__device__ __forceinline__ float* out_row(const RowMap& R, int r) {
    if (r < MPROMPT) { const int b = r >= LP ? 1 : 0, t = r - b * LP; return t < 16 ? nullptr : R.yp + ((size_t)(b * 8192 + t - 16)) * D; }
    const int s = r - MPROMPT; return s < MSAMP ? R.ys + (size_t)s * D : nullptr;
}

namespace pg8 {
#define PG8_LAS __attribute__((address_space(3)))
constexpr int BM = 256, BK = 64, HALF = 128, HTB = HALF * BK * 2  , STAGE_BYTES = 8 * HTB, NXCD = 8, WGM = 8;

__host__ __device__ __forceinline__ int lds_byte(int r, int c) { const int st = (r >> 4) * 2 + (c >> 5), rr = r & 15, cc = c & 31, ob = rr * 64 + cc * 2; return st * 1024 + (ob ^ (((ob >> 9) & 1) << 5)); }
__host__ __device__ __forceinline__ void stage_rc(int b, int& R, int& C) { const int st = b / 1024, sb = b % 1024, swz = sb ^ (((sb >> 9) & 1) << 5); R = (st >> 1) * 16 + swz / 64; C = (st & 1) * 32 + (swz % 64) / 2; }
__host__ __device__ __forceinline__ int perm32(int rho) { const int n = rho >> 4, i = rho & 15; return 8 * (i >> 2) + 4 * n + (i & 3); }

struct Unit { int pm, pn; };
struct Gemm { const bf16_t* A; const bf16_t* Bt; int lda; int K; int a_pn_bytes; };

struct StaticOrder {
    int nM, nN, nwg, G, c;
    __host__ __device__ void init(int nM_, int nN_, int G_, int c_) { nM = nM_; nN = nN_; nwg = nM * nN; G = G_; c = c_; }
    __host__ __device__ bool next(int i, Unit& u) const {
        const long L = (long)i * G + c; if (L >= nwg) return false;
        int wgid = (int)L; { const int q = nwg / NXCD, r = nwg % NXCD, xcd = wgid % NXCD, off = wgid / NXCD; wgid = (xcd < r ? xcd * (q + 1) : r * (q + 1) + (xcd - r) * q) + off; }
        const int nig = WGM * nN, gid = wgid / nig, fm = gid * WGM, gsz = (nM - fm) < WGM ? (nM - fm) : WGM;
        u.pm = fm + ((wgid % nig) % gsz); u.pn = (wgid % nig) / gsz; return true;
    }
    __device__ __forceinline__ void a_ready(const Unit&) const {}
    __device__ __forceinline__ void done(const Unit&) const {}
};

typedef f32x4 Acc[2][2][4][2];

struct EpiBf16 {
    static constexpr bool PERM = true;
    bf16_t* O; int ldc;
    __device__ __forceinline__ void operator()(const Acc& acc, const Unit& u, int wr, int wc, int fr, int fq) const {
        const int row0 = u.pm * BM + wr * 64 + fr, col0 = u.pn * BM + wc * 32 + 8 * fq;
#pragma unroll
        for (int ai = 0; ai < 2; ++ai)
#pragma unroll
            for (int m = 0; m < 4; ++m) { bf16_t* rowp = O + (size_t)(row0 + ai * HALF + m * 16) * ldc + col0;
#pragma unroll
                for (int bj = 0; bj < 2; ++bj) { const f32x4 v0 = acc[ai][bj][m][0], v1 = acc[ai][bj][m][1];
                    u32x4 w; w.x = cvt_pk_bf16(v0[0], v0[1]); w.y = cvt_pk_bf16(v0[2], v0[3]); w.z = cvt_pk_bf16(v1[0], v1[1]); w.w = cvt_pk_bf16(v1[2], v1[3]);
                    *(u32x4*)(rowp + bj * HALF) = w; } }
    }
};
struct EpiHid {
    static constexpr bool PERM = true;
    bf16_t* O; int ldc; const float* SS;
    __device__ __forceinline__ void operator()(const Acc& acc, const Unit& u, int wr, int wc, int fr, int fq) const {
        const int row0 = u.pm * BM + wr * 64 + fr, col0 = u.pn * BM + wc * 32 + 8 * fq;
#pragma unroll
        for (int ai = 0; ai < 2; ++ai)
#pragma unroll
            for (int m = 0; m < 4; ++m) { const int row = row0 + ai * HALF + m * 16;
                const f32x4 s4 = *(const f32x4*)(SS + (size_t)row * 16 + 4 * fq); float s = (s4[0] + s4[1]) + (s4[2] + s4[3]);
                s += __shfl_xor(s, 16); s += __shfl_xor(s, 32);
                const float rstd = rsqrtf(s * (1.0f / D) + EPS);
                bf16_t* rowp = O + (size_t)row * ldc + col0;
#pragma unroll
                for (int bj = 0; bj < 2; ++bj) { f32x4 v0 = acc[ai][bj][m][0] * rstd, v1 = acc[ai][bj][m][1] * rstd;
#pragma unroll
                    for (int e = 0; e < 4; ++e) { const float a = fmaxf(v0[e], 0.f), b = fmaxf(v1[e], 0.f); v0[e] = a * a; v1[e] = b * b; }
                    u32x4 w; w.x = cvt_pk_bf16(v0[0], v0[1]); w.y = cvt_pk_bf16(v0[2], v0[3]); w.z = cvt_pk_bf16(v1[0], v1[1]); w.w = cvt_pk_bf16(v1[2], v1[3]);
                    *(u32x4*)(rowp + bj * HALF) = w; }
                asm volatile("" ::: "memory"); }
    }
};
template <int BASE, int OUT, bool WXB, bool WSS, bool SCALE> struct EpiRes {
    static constexpr bool PERM = false;
    RowMap R; float* X; bf16_t* XB; float* SS; const float* scale;
    __device__ __forceinline__ void operator()(const Acc& acc, const Unit& u, int wr, int wc, int fr, int fq) const {
        const int row0 = u.pm * BM + wr * 64 + fr, col0 = u.pn * BM + wc * 32 + 4 * fq;
#pragma unroll
        for (int ai = 0; ai < 2; ++ai)
#pragma unroll
            for (int m = 0; m < 4; ++m) { const int row = row0 + ai * HALF + m * 16;
                const float* bp = BASE == 0 ? in_row(R, row) : X + (size_t)row * D;
                float* op = OUT == 0 ? X + (size_t)row * D : out_row(R, row);
                float ss = 0.f;
#pragma unroll
                for (int bj = 0; bj < 2; ++bj)
#pragma unroll
                    for (int n = 0; n < 2; ++n) { const int col = col0 + bj * HALF + n * 16;
                        f32x4 a = acc[ai][bj][m][n]; if (SCALE) a = a * *(const f32x4*)(scale + col);
                        const f32x4 v = *(const f32x4*)(bp + col) + a;
                        if (OUT == 0) *(f32x4*)(op + col) = v; else if (op) *(f32x4*)(op + col) = v;
                        if (WXB) { u32x2 w; w.x = cvt_pk_bf16(v[0], v[1]); w.y = cvt_pk_bf16(v[2], v[3]); *(u32x2*)(XB + (size_t)row * D + col) = w; }
                        if (WSS) ss += (v[0] * v[0] + v[1] * v[1]) + (v[2] * v[2] + v[3] * v[3]); }
                if (WSS) { ss += __shfl_xor(ss, 16); ss += __shfl_xor(ss, 32); if (fq == 0) SS[(size_t)row * 16 + u.pn * 4 + wc] = ss; }
                asm volatile("" ::: "memory");
            }
    }
};

template <class Epi, class Sched>
__device__ __forceinline__ void gemm_phase(PG8_LAS unsigned char* lds, const Gemm g, const Sched& S, const Epi& E) {
    const int tid = threadIdx.x, wid = __builtin_amdgcn_readfirstlane(tid >> 6), lane = tid & 63, wr = wid >> 2, wc = wid & 3, fr = lane & 15, fq = lane >> 4;
    const int K = g.K, nt = K / BK, lda = g.lda;
    unsigned voffA[2], voffB[2];
#pragma unroll
    for (int i = 0; i < 2; ++i) { int R, C; stage_rc(tid * 16 + i * 8192, R, C); const int Rb = Epi::PERM ? ((R & ~31) + perm32(R & 31)) : R;
        voffA[i] = (unsigned)(R * lda + C) * 2u; voffB[i] = (unsigned)(Rb * K + C) * 2u; }
    const size_t kstep = (size_t)(BK * 2);
    const size_t hA = (size_t)HALF * lda * 2, hB = (size_t)HALF * K * 2;
    const size_t tA = 2 * hA, tB = 2 * hB;
    const unsigned ldsw = (unsigned)wid * 1024u;
    const int aoff = lds_byte(wr * 64 + fr, fq * 8), boff = lds_byte(wc * 32 + fr, fq * 8);
#define PG8_UA(u) ((const char*)g.A + (size_t)(u).pm * tA + (size_t)(u).pn * (size_t)g.a_pn_bytes)
#define PG8_UB(u) ((const char*)g.Bt + (size_t)(u).pn * tB)
#define PG8_SA(b, h) (((b) * 2 + (h)) * HTB)
#define PG8_SB(b, h) ((4 + (b) * 2 + (h)) * HTB)
#define PG8_STAGE(bufoff, gbase, voff) do { _Pragma("unroll") for (int _i = 0; _i < 2; ++_i) \
        __builtin_amdgcn_global_load_lds((const unsigned*)((const char*)(gbase) + (voff)[_i]), (PG8_LAS unsigned*)(lds + (bufoff) + ldsw + _i * 8192), 16, 0, 0); } while (0)
#define PG8_LDA(dst, b, h) do { _Pragma("unroll") for (int m = 0; m < 4; ++m) _Pragma("unroll") for (int k = 0; k < 2; ++k) dst[m][k] = *(const PG8_LAS bf16x8*)(lds + PG8_SA(b, h) + aoff + m * 2048 + k * 1024); } while (0)
#define PG8_LDB(dst, b, h) do { _Pragma("unroll") for (int n = 0; n < 2; ++n) _Pragma("unroll") for (int k = 0; k < 2; ++k) dst[n][k] = *(const PG8_LAS bf16x8*)(lds + PG8_SB(b, h) + boff + n * 2048 + k * 1024); } while (0)
#define PG8_MMA(ai, bj, At, Bt) do { __builtin_amdgcn_s_setprio(1); _Pragma("unroll") for (int m = 0; m < 4; ++m) _Pragma("unroll") for (int n = 0; n < 2; ++n) _Pragma("unroll") for (int k = 0; k < 2; ++k) \
        acc[ai][bj][m][n] = __builtin_amdgcn_mfma_f32_16x16x32_bf16(Bt[n][k], At[m][k], acc[ai][bj][m][n], 0, 0, 0); __builtin_amdgcn_s_setprio(0); } while (0)
#define PG8_WAIT_V(n) asm volatile("s_waitcnt vmcnt(" #n ")" ::: "memory")
#define PG8_WAIT_L(n) asm volatile("s_waitcnt lgkmcnt(" #n ")" ::: "memory")
#define PG8_BAR __builtin_amdgcn_s_barrier()
#define PG8_SCHED __builtin_amdgcn_sched_barrier(0)
    Unit cur, nxt; int ui = 0;
    if (!S.next(0, cur)) return;
    Acc acc;
#pragma unroll
    for (int a = 0; a < 2; ++a)
#pragma unroll
        for (int b = 0; b < 2; ++b)
#pragma unroll
            for (int m = 0; m < 4; ++m)
#pragma unroll
                for (int n = 0; n < 2; ++n) acc[a][b][m][n] = (f32x4){0.f, 0.f, 0.f, 0.f};
    bf16x8 At[4][2], B0[2][2], B1[2][2];
    const char* cA = PG8_UA(cur); const char* cB = PG8_UB(cur);
    S.a_ready(cur);
    PG8_STAGE(PG8_SB(0, 0), cB, voffB); PG8_STAGE(PG8_SB(0, 1), cB + hB, voffB); PG8_STAGE(PG8_SA(0, 0), cA, voffA); PG8_STAGE(PG8_SA(0, 1), cA + hA, voffA);
    if (wr == 1) PG8_BAR;
    PG8_WAIT_V(2); PG8_BAR;
    PG8_STAGE(PG8_SB(1, 0), cB + kstep, voffB); PG8_STAGE(PG8_SA(1, 0), cA + kstep, voffA); PG8_STAGE(PG8_SB(1, 1), cB + hB + kstep, voffB);
    PG8_WAIT_V(6); PG8_BAR;
    for (;;) {
        const bool has_next = S.next(ui + 1, nxt);
        const char* nA = has_next ? PG8_UA(nxt) : cA; const char* nB = has_next ? PG8_UB(nxt) : cB;
#pragma unroll 1
        for (int t = 0; t < nt; t += 2) {
            const bool last = (t == nt - 2);
            const char* a1 = cA + (size_t)(t + 1) * kstep;
            const char* a2 = last ? nA : cA + (size_t)(t + 2) * kstep; const char* b2 = last ? nB : cB + (size_t)(t + 2) * kstep;
            const char* a3 = a2 + kstep; const char* b3 = b2 + kstep;
            if (last && has_next) S.a_ready(nxt);
            PG8_LDB(B0, 0, 0); PG8_LDB(B1, 0, 1); PG8_SCHED; PG8_LDA(At, 0, 0); PG8_STAGE(PG8_SA(1, 1), a1 + hA, voffA);
            PG8_WAIT_V(8); PG8_WAIT_L(0); PG8_BAR; PG8_MMA(0, 0, At, B0); PG8_MMA(0, 1, At, B1); PG8_BAR; PG8_SCHED;
            PG8_LDA(At, 0, 1); PG8_STAGE(PG8_SB(0, 0), b2, voffB); PG8_STAGE(PG8_SB(0, 1), b2 + hB, voffB); PG8_STAGE(PG8_SA(0, 0), a2, voffA);
            PG8_WAIT_V(8); PG8_WAIT_L(0); PG8_BAR; PG8_MMA(1, 0, At, B0); PG8_MMA(1, 1, At, B1); PG8_BAR; PG8_SCHED;
            PG8_LDB(B0, 1, 0); PG8_LDB(B1, 1, 1); PG8_SCHED; PG8_LDA(At, 1, 0); PG8_STAGE(PG8_SA(0, 1), a2 + hA, voffA);
            PG8_WAIT_V(8); PG8_WAIT_L(0); PG8_BAR; PG8_MMA(0, 0, At, B0); PG8_MMA(0, 1, At, B1); PG8_BAR; PG8_SCHED;
            PG8_LDA(At, 1, 1); PG8_STAGE(PG8_SB(1, 0), b3, voffB); PG8_STAGE(PG8_SB(1, 1), b3 + hB, voffB); PG8_STAGE(PG8_SA(1, 0), a3, voffA);
            PG8_WAIT_V(8); PG8_WAIT_L(0); PG8_BAR; PG8_MMA(1, 0, At, B0); PG8_MMA(1, 1, At, B1); PG8_BAR; PG8_SCHED;
        }
        if (wr == 0) PG8_BAR;
        E(acc, cur, wr, wc, fr, fq); S.done(cur);
        if (!has_next) break;
#pragma unroll
        for (int a = 0; a < 2; ++a)
#pragma unroll
            for (int b = 0; b < 2; ++b)
#pragma unroll
                for (int m = 0; m < 4; ++m)
#pragma unroll
                    for (int n = 0; n < 2; ++n) acc[a][b][m][n] = (f32x4){0.f, 0.f, 0.f, 0.f};
        cur = nxt; cA = nA; cB = nB; ++ui;
        if (wr == 1) PG8_BAR;
    }
    PG8_WAIT_V(0);
    PG8_BAR;
#undef PG8_UA
#undef PG8_UB
#undef PG8_SA
#undef PG8_SB
#undef PG8_STAGE
#undef PG8_LDA
#undef PG8_LDB
#undef PG8_MMA
#undef PG8_WAIT_V
#undef PG8_WAIT_L
#undef PG8_BAR
#undef PG8_SCHED
}
}

#define RLX_AGENT __ATOMIC_RELAXED, __HIP_MEMORY_SCOPE_AGENT
#define LDS_WAIT() asm volatile("s_waitcnt lgkmcnt(0)" ::: "memory")
#define VM_WAIT() asm volatile("s_waitcnt vmcnt(0)" ::: "memory")
#define XB_TMO      128
#define XB_XCNT(j)  (256  + 64 * (j))
#define XB_XSUB(j)  (1280 + 64 * (j))
#define XB_XGEN(j)  (2304 + 64 * (j))
#define XB_TOP      3328
#define XB_TOPGEN   3392
#define XCD_BAR_WORDS 3456
#define XB_SPIN_CAP (1u << 18)
__device__ __forceinline__ unsigned xb_ld(unsigned* p)              { return __hip_atomic_load(p, __ATOMIC_RELAXED, __HIP_MEMORY_SCOPE_AGENT); }
__device__ __forceinline__ unsigned xb_add(unsigned* p, unsigned v) { return __hip_atomic_fetch_add(p, v, __ATOMIC_RELAXED, __HIP_MEMORY_SCOPE_AGENT); }
__device__ __forceinline__ unsigned xb_xcc_id() { return (unsigned)__builtin_amdgcn_s_getreg((3 << 11) | 20) & 0xFu; }
#define XB_SPIN(cond, bar) do { unsigned _sp = 0; while (cond) { __builtin_amdgcn_s_sleep(1); \
    if ((++_sp & 255u) == 0u) { if (xb_ld(&(bar)[XB_TMO])) break; if (_sp > XB_SPIN_CAP) { atomicAdd(&(bar)[XB_TMO], 1u); break; } } } } while (0)
struct XcdBarrier { unsigned* bar; unsigned x; volatile LAS unsigned* st; };
__device__ __forceinline__ XcdBarrier xcd_barrier_post(unsigned* bar, volatile LAS unsigned* st) {
    XcdBarrier b; b.bar = bar; b.x = xb_xcc_id(); b.st = st;
    if (threadIdx.x == 0) (void)xb_add(&bar[XB_XCNT(b.x)], 1u);
    return b;
}
__device__ __forceinline__ void xcd_barrier_complete(unsigned* bar, unsigned x, unsigned& nloc, unsigned& nx) {
    const unsigned G = gridDim.x * gridDim.y * gridDim.z;
    unsigned sum, cnt, mine, sp = 0u;
    for (;;) {
        sum = 0u; cnt = 0u; mine = 0u;
#pragma unroll
        for (unsigned j = 0; j < 16; ++j) { const unsigned c = xb_ld(&bar[XB_XCNT(j)]); sum += c; cnt += (c > 0u) ? 1u : 0u; mine = (j == x) ? c : mine; }
        if (sum == G) break;
        __builtin_amdgcn_s_sleep(1);
        if ((++sp & 255u) == 0u) { if (xb_ld(&bar[XB_TMO])) break; if (sp > XB_SPIN_CAP) { atomicAdd(&bar[XB_TMO], 1u); break; } }
    }
    nloc = mine > 0u ? mine : 1u; nx = cnt > 0u ? cnt : 1u;
}
__device__ __forceinline__ void xcd_barrier(const XcdBarrier& b) {
    asm volatile("s_waitcnt vmcnt(0)" ::: "memory");
    __syncthreads();
    if (threadIdx.x == 0) {
        unsigned* bar = b.bar;
        __builtin_amdgcn_s_waitcnt(0);
        unsigned nloc = b.st[0], nx = b.st[1];
        if (nloc == 0u) { xcd_barrier_complete(bar, b.x, nloc, nx); b.st[0] = nloc; b.st[1] = nx; }
        const unsigned old = xb_add(&bar[XB_XSUB(b.x)], 1u);
        const unsigned gen = old / nloc;
        if (old + 1u == (gen + 1u) * nloc) {
            __builtin_amdgcn_fence(__ATOMIC_RELEASE, "agent");
            asm volatile("s_waitcnt vmcnt(0)" ::: "memory");
            const unsigned og = xb_add(&bar[XB_TOP], 1u);
            const unsigned tg = og / nx;
            if (og + 1u == (tg + 1u) * nx) xb_add(&bar[XB_TOPGEN], 1u);
            else XB_SPIN(xb_ld(&bar[XB_TOPGEN]) == tg, bar);
            __builtin_amdgcn_fence(__ATOMIC_ACQUIRE, "agent");
            xb_add(&bar[XB_XGEN(b.x)], 1u);
            asm volatile("s_waitcnt vmcnt(0)" ::: "memory");
        } else {
            XB_SPIN(xb_ld(&bar[XB_XGEN(b.x)]) == gen, bar);
            __builtin_amdgcn_fence(__ATOMIC_ACQUIRE, "agent");
            asm volatile("s_waitcnt vmcnt(0)" ::: "memory");
        }
    }
    __syncthreads();
}

constexpr int NWAVES = 8;
constexpr int RING_BYTES = 131072;
constexpr int MISC_OFF = RING_BYTES + 320;
constexpr int LDS_BYTES = 147456;
constexpr int CW_BAR = 4096;

struct Args {
    const float* in[19]; float* out; unsigned char* ws;
};

struct Frame {
    LAS unsigned char* lds;
    int tid, lane, wave, G, bid;
};

__device__ __forceinline__ float wave_sum(float v) {
#pragma unroll
    for (int o = 1; o < 64; o <<= 1) v += __shfl_xor(v, o);
    return v;
}
__device__ __forceinline__ float wave_max(float v) {
#pragma unroll
    for (int o = 1; o < 64; o <<= 1) v = fmaxf(v, __shfl_xor(v, o));
    return v;
}

__device__ __forceinline__ void p0_transpose_item(const float* W, int K, int N, bf16_t* WT, LAS float* scr, int item, int lane, const float* gs) {
    const int nblk = N / 32, kb = item / nblk, nb = item % nblk, k0 = 64 * kb, n0 = 32 * nb;
#pragma unroll 8
    for (int i = 0; i < 32; ++i) { const int kk = 2 * i + (lane >> 5); float w = W[(size_t)(k0 + kk) * N + n0 + (lane & 31)]; if (gs) w *= gs[k0 + kk]; scr[kk * 33 + (lane & 31)] = w; }
    LDS_WAIT(); asm volatile("" ::: "memory");
    const int c = lane & 7;
#pragma unroll
    for (int j = 0; j < 4; ++j) { const int n = (lane >> 3) + 8 * j; const LAS float* s = scr + (8 * c) * 33 + n;
        u32x4 o; o.x = cvt_pk_bf16(s[0 * 33], s[1 * 33]); o.y = cvt_pk_bf16(s[2 * 33], s[3 * 33]); o.z = cvt_pk_bf16(s[4 * 33], s[5 * 33]); o.w = cvt_pk_bf16(s[6 * 33], s[7 * 33]);
        *(GAS u32x4*)(WT + (size_t)(n0 + n) * K + k0 + 8 * c) = o; }
    LDS_WAIT(); asm volatile("" ::: "memory");
}

__device__ __forceinline__ void p0_prologue(Frame& F, const Args& a) {
    LAS float* scr = (LAS float*)(F.lds + F.wave * 16384);
    const int gw = F.bid * NWAVES + F.wave, NGW = F.G * NWAVES;
    unsigned char* ws = a.ws;
    constexpr int I_IN = (D / 64) * (DIN / 32), I_OUT = (D / 64) * (D / 32), I_UP = (D / 64) * (FF / 32), I_DN = (FF / 64) * (D / 32), I_PL = (256 / 64) * (256 / 32);
    constexpr int NITEMS = I_IN + I_OUT + 2 * I_UP + 2 * I_DN + 4 * I_PL;
    for (int it = gw; it < NITEMS; it += NGW) {
        int r = it;
        if (r < I_IN) { p0_transpose_item(a.in[9], D, DIN, (bf16_t*)(ws + WS_WIN), scr, r, F.lane, nullptr); continue; } r -= I_IN;
        if (r < I_OUT) { p0_transpose_item(a.in[14], D, D, (bf16_t*)(ws + WS_WOUT), scr, r, F.lane, nullptr); continue; } r -= I_OUT;
        if (r < I_UP) { p0_transpose_item(a.in[17], D, FF, (bf16_t*)(ws + WS_WUP0), scr, r, F.lane, a.in[8]); continue; } r -= I_UP;
        if (r < I_UP) { p0_transpose_item(a.in[17] + (size_t)D * FF, D, FF, (bf16_t*)(ws + WS_WUP1), scr, r, F.lane, a.in[8] + D); continue; } r -= I_UP;
        if (r < I_DN) { p0_transpose_item(a.in[18], FF, D, (bf16_t*)(ws + WS_WDN0), scr, r, F.lane, nullptr); continue; } r -= I_DN;
        if (r < I_DN) { p0_transpose_item(a.in[18] + (size_t)D * FF, FF, D, (bf16_t*)(ws + WS_WDN1), scr, r, F.lane, nullptr); continue; } r -= I_DN;
        { const int gi = r / I_PL; p0_transpose_item(a.in[15] + (size_t)gi * 65536, 256, 256, (bf16_t*)(ws + WS_WPOOL) + (size_t)gi * 65536, scr, r % I_PL, F.lane, nullptr); }
    }
    RowMap R{a.in[0], a.in[1], a.in[6], nullptr, nullptr};
    const float* g0 = a.in[7];
    bf16_t* H0 = (bf16_t*)(ws + WS_H0);
    for (int m = gw; m < M; m += NGW) {
        const GAS f32x4* xr = (const GAS f32x4*)in_row(R, m) + F.lane;
        f32x4 v[4]; float s = 0.f;
#pragma unroll
        for (int j = 0; j < 4; ++j) { v[j] = xr[64 * j]; s += (v[j][0] * v[j][0] + v[j][1] * v[j][1]) + (v[j][2] * v[j][2] + v[j][3] * v[j][3]); }
        const float rstd = rsqrtf(wave_sum(s) * (1.f / D) + EPS);
        GAS u32x2* o8 = (GAS u32x2*)(H0 + (size_t)m * D) + F.lane;
#pragma unroll
        for (int j = 0; j < 4; ++j) { const f32x4 gg = *((const GAS f32x4*)g0 + F.lane + 64 * j);
            u32x2 w; w.x = cvt_pk_bf16(v[j][0] * rstd * gg[0], v[j][1] * rstd * gg[1]); w.y = cvt_pk_bf16(v[j][2] * rstd * gg[2], v[j][3] * rstd * gg[3]); o8[64 * j] = w; }
    }
}

constexpr int KP = 144;
constexpr int VP = 392;
constexpr int LDS_K = 0, LDS_VT = 192 * KP;
constexpr float C2 = 0.125f * LOG2E;

__device__ __forceinline__ void attn_prompt_unit(Frame& F, const Args& a, int b, int kh, int qb) {
    const bf16_t* Z = (const bf16_t*)(a.ws + WS_Z);
    bf16_t* MIX = (bf16_t*)(a.ws + WS_MIX);
    const float* qnorm = a.in[11]; const float* knorm = a.in[12]; const float* sinks = a.in[13];
    float* kout = a.out + O_KP; float* vout = a.out + O_VP;
    LAS unsigned char* lds = F.lds;
    const int t0 = qb * 64, rowbase = b * LP;
    const int tid = F.tid, lane = F.lane;
#pragma unroll
    for (int i = 0; i < 3; ++i) {
        const int c = tid + 512 * i, kl = c >> 3, dc = c & 7, t = t0 - 128 + kl;
        const bool valid = (t >= 0) && (t < LP);
        u32x4 kr = (u32x4){0u, 0u, 0u, 0u}, vr = (u32x4){0u, 0u, 0u, 0u};
        if (valid) { const bf16_t* zp = Z + (size_t)(rowbase + t) * DIN + 2048 + kh * 64 + dc * 8; kr = *(const u32x4*)zp; vr = *(const u32x4*)(zp + 128); }
        float kf[8]; kf[0] = bf_lo(kr.x); kf[1] = bf_hi(kr.x); kf[2] = bf_lo(kr.y); kf[3] = bf_hi(kr.y); kf[4] = bf_lo(kr.z); kf[5] = bf_hi(kr.z); kf[6] = bf_lo(kr.w); kf[7] = bf_hi(kr.w);
        float ss = 0.f;
#pragma unroll
        for (int e = 0; e < 8; ++e) ss += kf[e] * kf[e];
        ss += __shfl_xor(ss, 1); ss += __shfl_xor(ss, 2); ss += __shfl_xor(ss, 4);
        const float rstd = rsqrtf(ss * (1.f / 64.f) + EPS);
        const f32x4 g0 = *(const f32x4*)(knorm + dc * 8), g1 = *(const f32x4*)(knorm + dc * 8 + 4);
        kf[0] *= rstd * g0[0]; kf[1] *= rstd * g0[1]; kf[2] *= rstd * g0[2]; kf[3] *= rstd * g0[3];
        kf[4] *= rstd * g1[0]; kf[5] *= rstd * g1[1]; kf[6] *= rstd * g1[2]; kf[7] *= rstd * g1[3];
        if (kl >= 128 && valid && t >= LP - 128) {
            const size_t o = ((size_t)(b * 128 + (t - (LP - 128))) * 2 + kh) * 64 + dc * 8;
            *(f32x4*)(kout + o) = (f32x4){kf[0], kf[1], kf[2], kf[3]}; *(f32x4*)(kout + o + 4) = (f32x4){kf[4], kf[5], kf[6], kf[7]};
            *(f32x4*)(vout + o) = (f32x4){bf_lo(vr.x), bf_hi(vr.x), bf_lo(vr.y), bf_hi(vr.y)}; *(f32x4*)(vout + o + 4) = (f32x4){bf_lo(vr.z), bf_hi(vr.z), bf_lo(vr.w), bf_hi(vr.w)};
        }
        u32x4 kw; kw.x = cvt_pk_bf16(kf[0], kf[1]); kw.y = cvt_pk_bf16(kf[2], kf[3]); kw.z = cvt_pk_bf16(kf[4], kf[5]); kw.w = cvt_pk_bf16(kf[6], kf[7]);
        *(LAS u32x4*)(lds + LDS_K + kl * KP + dc * 16) = kw;
        LAS bf16_t* vt = (LAS bf16_t*)(lds + LDS_VT + (dc * 8) * VP + kl * 2);
        vt[0 * (VP / 2)] = (bf16_t)(vr.x & 0xffffu); vt[1 * (VP / 2)] = (bf16_t)(vr.x >> 16);
        vt[2 * (VP / 2)] = (bf16_t)(vr.y & 0xffffu); vt[3 * (VP / 2)] = (bf16_t)(vr.y >> 16);
        vt[4 * (VP / 2)] = (bf16_t)(vr.z & 0xffffu); vt[5 * (VP / 2)] = (bf16_t)(vr.z >> 16);
        vt[6 * (VP / 2)] = (bf16_t)(vr.w & 0xffffu); vt[7 * (VP / 2)] = (bf16_t)(vr.w >> 16);
    }
    __syncthreads();
    const int g = F.wave >> 1, qh = F.wave & 1, head = kh * 4 + g;
    const int r = lane & 31, hh = lane >> 5;
    const int tq = t0 + 32 * qh, q_t = tq + r;
    const int qrow = rowbase + (q_t < LP ? q_t : LP - 1);
    bf16x8 qf[4];
    {
        float qv[4][8]; float ss = 0.f;
#pragma unroll
        for (int s = 0; s < 4; ++s) { const u32x4 raw = *(const u32x4*)(Z + (size_t)qrow * DIN + 1536 + head * 64 + 16 * s + 8 * hh);
            qv[s][0] = bf_lo(raw.x); qv[s][1] = bf_hi(raw.x); qv[s][2] = bf_lo(raw.y); qv[s][3] = bf_hi(raw.y); qv[s][4] = bf_lo(raw.z); qv[s][5] = bf_hi(raw.z); qv[s][6] = bf_lo(raw.w); qv[s][7] = bf_hi(raw.w);
#pragma unroll
            for (int e = 0; e < 8; ++e) ss += qv[s][e] * qv[s][e]; }
        ss += __shfl_xor(ss, 32);
        const float rstd = rsqrtf(ss * (1.f / 64.f) + EPS) * C2;
#pragma unroll
        for (int s = 0; s < 4; ++s) { const f32x4 g0 = *(const f32x4*)(qnorm + 16 * s + 8 * hh), g1 = *(const f32x4*)(qnorm + 16 * s + 8 * hh + 4);
            u32x4 w; w.x = cvt_pk_bf16(qv[s][0] * rstd * g0[0], qv[s][1] * rstd * g0[1]); w.y = cvt_pk_bf16(qv[s][2] * rstd * g0[2], qv[s][3] * rstd * g0[3]);
            w.z = cvt_pk_bf16(qv[s][4] * rstd * g1[0], qv[s][5] * rstd * g1[1]); w.w = cvt_pk_bf16(qv[s][6] * rstd * g1[2], qv[s][7] * rstd * g1[3]);
            qf[s] = __builtin_bit_cast(bf16x8, w); }
    }
    f32x16 sc[5];
#pragma unroll
    for (int i = 0; i < 5; ++i) {
#pragma unroll
        for (int e = 0; e < 16; ++e) sc[i][e] = 0.f;
#pragma unroll
        for (int s = 0; s < 4; ++s) { const bf16x8 kfr = *(const LAS bf16x8*)(lds + LDS_K + (32 * qh + 32 * i + r) * KP + (16 * s + 8 * hh) * 2);
            sc[i] = __builtin_amdgcn_mfma_f32_32x32x16_bf16(kfr, qf[s], sc[i], 0, 0, 0); }
    }
    const float sinkl = sinks[head] * LOG2E;
    const int kmin = 128 - tq;
    float mx = -INFINITY;
#pragma unroll
    for (int i = 0; i < 5; ++i)
#pragma unroll
        for (int e = 0; e < 16; ++e) { const int krel = 32 * i + (e & 3) + 8 * (e >> 2) + 4 * hh;
            const bool ok = (krel >= r) && (krel <= r + 128) && (krel >= kmin);
            const float v = ok ? sc[i][e] : -INFINITY; sc[i][e] = v; mx = fmaxf(mx, v); }
    mx = fmaxf(mx, __shfl_xor(mx, 32)); mx = fmaxf(mx, sinkl);
    float l = 0.f;
#pragma unroll
    for (int i = 0; i < 5; ++i)
#pragma unroll
        for (int e = 0; e < 16; ++e) { const float p = __builtin_amdgcn_exp2f(sc[i][e] - mx); sc[i][e] = p; l += p; }
    l += __shfl_xor(l, 32); l += __builtin_amdgcn_exp2f(sinkl - mx);
    const float inv = 1.0f / l;
    f32x16 o[2];
#pragma unroll
    for (int dt = 0; dt < 2; ++dt)
#pragma unroll
        for (int e = 0; e < 16; ++e) o[dt][e] = 0.f;
#pragma unroll
    for (int i = 0; i < 5; ++i)
#pragma unroll
        for (int s2 = 0; s2 < 2; ++s2) {
            u32x4 pw; pw.x = cvt_pk_bf16(sc[i][8 * s2 + 0], sc[i][8 * s2 + 1]); pw.y = cvt_pk_bf16(sc[i][8 * s2 + 2], sc[i][8 * s2 + 3]);
            pw.z = cvt_pk_bf16(sc[i][8 * s2 + 4], sc[i][8 * s2 + 5]); pw.w = cvt_pk_bf16(sc[i][8 * s2 + 6], sc[i][8 * s2 + 7]);
            const bf16x8 pf = __builtin_bit_cast(bf16x8, pw);
#pragma unroll
            for (int dt = 0; dt < 2; ++dt) {
                const LAS unsigned char* vb = lds + LDS_VT + (32 * dt + r) * VP + (32 * qh + 32 * i + 16 * s2 + 4 * hh) * 2;
                const u32x2 lo = *(const LAS u32x2*)vb, hi = *(const LAS u32x2*)(vb + 16);
                u32x4 vw; vw.x = lo.x; vw.y = lo.y; vw.z = hi.x; vw.w = hi.y;
                o[dt] = __builtin_amdgcn_mfma_f32_32x32x16_bf16(__builtin_bit_cast(bf16x8, vw), pf, o[dt], 0, 0, 0);
            }
        }
    if (q_t < LP) {
        bf16_t* op = MIX + (size_t)(rowbase + q_t) * D + 512 + head * 64;
#pragma unroll
        for (int dt = 0; dt < 2; ++dt)
#pragma unroll
            for (int i4 = 0; i4 < 4; ++i4) { u32x2 w; w.x = cvt_pk_bf16(o[dt][4 * i4 + 0] * inv, o[dt][4 * i4 + 1] * inv); w.y = cvt_pk_bf16(o[dt][4 * i4 + 2] * inv, o[dt][4 * i4 + 3] * inv);
                *(u32x2*)(op + 32 * dt + 8 * i4 + 4 * hh) = w; }
    }
    __syncthreads();
}

constexpr int SK_P = 65;
constexpr int LDS_SKC = 0, LDS_SVC = 132 * SK_P * 4, LDS_SQ = LDS_SVC + 132 * 64 * 4, LDS_SP = LDS_SQ + 16 * 64 * 4;
__device__ __forceinline__ void attn_sample_item(Frame& F, const Args& a, int bd, int kh) {
    const bf16_t* Z = (const bf16_t*)(a.ws + WS_Z);
    bf16_t* MIX = (bf16_t*)(a.ws + WS_MIX);
    const float* ck = a.in[3]; const float* cv = a.in[4];
    const float* qnorm = a.in[11]; const float* knorm = a.in[12]; const float* sinks = a.in[13];
    float* kout = a.out + O_KS; float* vout = a.out + O_VS;
    LAS float* Kc = (LAS float*)(F.lds + LDS_SKC); LAS float* Vc = (LAS float*)(F.lds + LDS_SVC); LAS float* Qs = (LAS float*)(F.lds + LDS_SQ);
    LAS float* Pw = (LAS float*)(F.lds + LDS_SP) + F.wave * 132;
    const int tid = F.tid, lane = F.lane, w = F.wave;
    const int row0 = MPROMPT + bd * 4;
    for (int idx = tid; idx < 128 * 64; idx += 512) { const int j = idx >> 6, d = idx & 63;
        const size_t gi = ((size_t)(bd * 128 + j) * 2 + kh) * 64 + d; const float kv = ck[gi], vv = cv[gi];
        Kc[j * SK_P + d] = kv; Vc[j * 64 + d] = vv;
        if (j >= 4) { const size_t oi = ((size_t)(bd * 128 + j - 4) * 2 + kh) * 64 + d; kout[oi] = kv; vout[oi] = vv; } }
    if (w < 4) { const bf16_t* zp = Z + (size_t)(row0 + w) * DIN + 2048 + kh * 64 + lane; const float kr = bf1(zp[0]), vr = bf1(zp[128]);
        const float rstd = rsqrtf(wave_sum(kr * kr) * (1.f / 64.f) + EPS); const float kn = kr * rstd * knorm[lane];
        Kc[(128 + w) * SK_P + lane] = kn; Vc[(128 + w) * 64 + lane] = vr;
        const size_t oi = ((size_t)(bd * 128 + 124 + w) * 2 + kh) * 64 + lane; kout[oi] = kn; vout[oi] = vr; }
#pragma unroll
    for (int rr = 0; rr < 2; ++rr) { const int row = 2 * w + rr, i = row >> 2, g = row & 3;
        const float qr = bf1(Z[(size_t)(row0 + i) * DIN + 1536 + (kh * 4 + g) * 64 + lane]);
        const float rstd = rsqrtf(wave_sum(qr * qr) * (1.f / 64.f) + EPS);
        Qs[row * 64 + lane] = qr * rstd * qnorm[lane] * C2; }
    __syncthreads();
#pragma unroll 1
    for (int rr = 0; rr < 2; ++rr) { const int row = 2 * w + rr, i = row >> 2, g = row & 3, head = kh * 4 + g;
        const float sinkl = sinks[head] * LOG2E;
        float s[3];
#pragma unroll
        for (int kk = 0; kk < 3; ++kk) { const int e = lane + 64 * kk; const int ec = e < 132 ? e : 131; float acc = 0.f;
#pragma unroll 16
            for (int d = 0; d < 64; ++d) acc += Qs[row * 64 + d] * Kc[ec * SK_P + d];
            s[kk] = (e >= i && e <= 128 + i) ? acc : -INFINITY; }
        float mx = wave_max(fmaxf(fmaxf(s[0], s[1]), s[2])); mx = fmaxf(mx, sinkl);
        float l = 0.f;
#pragma unroll
        for (int kk = 0; kk < 3; ++kk) { const int e = lane + 64 * kk; const float p = __builtin_amdgcn_exp2f(s[kk] - mx); l += p; if (e < 132) Pw[e] = p; }
        l = wave_sum(l) + __builtin_amdgcn_exp2f(sinkl - mx);
        LDS_WAIT(); asm volatile("" ::: "memory");
        float o = 0.f;
#pragma unroll 4
        for (int e = 0; e < 132; ++e) o += Pw[e] * Vc[e * 64 + lane];
        o /= l;
        MIX[(size_t)(row0 + i) * D + 512 + head * 64 + lane] = (bf16_t)(cvt_pk_bf16(o, 0.f) & 0xffffu);
        LDS_WAIT(); asm volatile("" ::: "memory");
    }
    __syncthreads();
}

__device__ __forceinline__ void conv_item(Frame& F, const Args& a, int item) {
    const bf16_t* Z = (const bf16_t*)(a.ws + WS_Z);
    bf16_t* MIX = (bf16_t*)(a.ws + WS_MIX);
    const float* cw = a.in[10]; const float* st = a.in[2];
    const int lane = F.lane, c8 = lane * 8;
    const int r0 = item * 128 + F.wave * 16;
    if (r0 >= M) return;
    float w0[8], w1[8], w2[8];
#pragma unroll
    for (int e = 0; e < 8; ++e) { w0[e] = cw[c8 + e]; w1[e] = cw[512 + c8 + e]; w2[e] = cw[1024 + c8 + e]; }
    float u1[8], u2[8];
#pragma unroll
    for (int e = 0; e < 8; ++e) { u1[e] = 0.f; u2[e] = 0.f; }
    const bool samp = r0 >= MPROMPT;
    if (!samp) { const int b = r0 >= LP ? 1 : 0, t = r0 - b * LP;
        if (t > 0) {
#pragma unroll
            for (int k = 1; k <= 2; ++k) { const bf16_t* zp = Z + (size_t)(r0 - k) * DIN + c8; const u32x4 xa = *(const u32x4*)zp, gc = *(const u32x4*)(zp + 512);
                float* u = k == 1 ? u1 : u2;
                u[0] = bf_lo(xa.x) * bf_lo(gc.x); u[1] = bf_hi(xa.x) * bf_hi(gc.x); u[2] = bf_lo(xa.y) * bf_lo(gc.y); u[3] = bf_hi(xa.y) * bf_hi(gc.y);
                u[4] = bf_lo(xa.z) * bf_lo(gc.z); u[5] = bf_hi(xa.z) * bf_hi(gc.z); u[6] = bf_lo(xa.w) * bf_lo(gc.w); u[7] = bf_hi(xa.w) * bf_hi(gc.w); }
        }
    }
#pragma unroll 1
    for (int k = 0; k < 16; ++k) { const int rrow = r0 + k;
        int b = 0, t = 0, bd = 0, i = 0;
        if (!samp) { b = rrow >= LP ? 1 : 0; t = rrow - b * LP; } else { bd = (rrow - MPROMPT) >> 2; i = (rrow - MPROMPT) & 3; }
        if (samp && i == 0) {
#pragma unroll
            for (int e = 0; e < 8; ++e) { u2[e] = st[(size_t)(bd * 2 + 0) * 512 + c8 + e]; u1[e] = st[(size_t)(bd * 2 + 1) * 512 + c8 + e]; }
        }
        const bf16_t* zp = Z + (size_t)rrow * DIN + c8; const u32x4 xa = *(const u32x4*)zp, gc = *(const u32x4*)(zp + 512), gb = *(const u32x4*)(zp + 1024);
        float u0[8], gbf[8], y[8];
        u0[0] = bf_lo(xa.x) * bf_lo(gc.x); u0[1] = bf_hi(xa.x) * bf_hi(gc.x); u0[2] = bf_lo(xa.y) * bf_lo(gc.y); u0[3] = bf_hi(xa.y) * bf_hi(gc.y);
        u0[4] = bf_lo(xa.z) * bf_lo(gc.z); u0[5] = bf_hi(xa.z) * bf_hi(gc.z); u0[6] = bf_lo(xa.w) * bf_lo(gc.w); u0[7] = bf_hi(xa.w) * bf_hi(gc.w);
        gbf[0] = bf_lo(gb.x); gbf[1] = bf_hi(gb.x); gbf[2] = bf_lo(gb.y); gbf[3] = bf_hi(gb.y); gbf[4] = bf_lo(gb.z); gbf[5] = bf_hi(gb.z); gbf[6] = bf_lo(gb.w); gbf[7] = bf_hi(gb.w);
#pragma unroll
        for (int e = 0; e < 8; ++e) y[e] = gbf[e] * (w0[e] * u2[e] + w1[e] * u1[e] + w2[e] * u0[e]);
        u32x4 o; o.x = cvt_pk_bf16(y[0], y[1]); o.y = cvt_pk_bf16(y[2], y[3]); o.z = cvt_pk_bf16(y[4], y[5]); o.w = cvt_pk_bf16(y[6], y[7]);
        *(u32x4*)(MIX + (size_t)rrow * D + c8) = o;
        float* po = nullptr;
        if (!samp) { if (t >= LP - 2) po = a.out + O_CONVP + (size_t)(b * 2 + (t - (LP - 2))) * 512 + c8; }
        else { if (i >= 2) po = a.out + O_CONVS + (size_t)(bd * 2 + (i - 2)) * 512 + c8; }
        if (po) { *(f32x4*)po = (f32x4){u0[0], u0[1], u0[2], u0[3]}; *(f32x4*)(po + 4) = (f32x4){u0[4], u0[5], u0[6], u0[7]}; }
#pragma unroll
        for (int e = 0; e < 8; ++e) { u2[e] = u1[e]; u1[e] = u0[e]; }
    }
}

constexpr int N_ATT_P = 2 * 2 * 129, N_ATT_S = 256, N_CONV = (M + 127) / 128;
__device__ __forceinline__ void mixer_phase(Frame& F, const Args& a) {
    for (int it = F.bid; it < N_ATT_P; it += F.G) { const int qb = it % 129, bk = it / 129; attn_prompt_unit(F, a, bk >> 1, bk & 1, qb); }
    asm volatile("" ::: "memory");
    for (int it = F.G - 1 - F.bid; it < N_CONV; it += F.G) conv_item(F, a, it);
    asm volatile("" ::: "memory");
    for (int it = F.bid; it < N_ATT_S; it += F.G) attn_sample_item(F, a, it >> 1, it & 1);
}

__device__ __forceinline__ float rstd_of(const float* SS, int row) {
    const f32x4* p = (const f32x4*)(SS + (size_t)row * 16); const f32x4 a = p[0], b = p[1], c = p[2], d = p[3];
    const float s = ((a[0] + a[1]) + (a[2] + a[3])) + ((b[0] + b[1]) + (b[2] + b[3])) + ((c[0] + c[1]) + (c[2] + c[3])) + ((d[0] + d[1]) + (d[2] + d[3]));
    return rsqrtf(s * (1.f / D) + EPS);
}
__device__ __forceinline__ void pool_phase(Frame& F, const Args& a) {
    const float* X = (const float*)(a.ws + WS_X); const float* SS = (const float*)(a.ws + WS_SS + SS_BYTES);
    bf16_t* DLT = (bf16_t*)(a.ws + WS_DLT);
    const float* gmix = a.in[7] + D; const float* stp = a.in[5];
    const int gw = F.bid * NWAVES + F.wave, NGW = F.G * NWAVES, lane = F.lane;
    constexpr int NCH = M / 16;
    for (int it = gw; it < NCH * 4; it += NGW) {
        const int gi = it & 3, ch = it >> 2, r0 = ch * 16, w = 2 << gi, c = gi * 256 + lane * 4;
        const f32x4 gg = *(const f32x4*)(gmix + c);
        const bool samp = r0 >= MPROMPT;
        if (!samp) {
            const int b = r0 >= LP ? 1 : 0, t0 = r0 - b * LP;
            float rs = 0.f; { const int rr = r0 - 15 + lane; if (lane < 31 && rr >= b * LP) rs = rstd_of(SS, rr); }
            f32x4 S = (f32x4){0.f, 0.f, 0.f, 0.f};
            for (int k = 1; k < w; ++k) { if (t0 - k >= 0) { const float rk = __shfl(rs, 15 - k); S += *(const f32x4*)(X + (size_t)(r0 - k) * D + c) * rk * gg; } }
#pragma unroll 1
            for (int k = 0; k < 16; ++k) { const int row = r0 + k, t = t0 + k;
                const float rk = __shfl(rs, 15 + k);
                const f32x4 h = *(const f32x4*)(X + (size_t)row * D + c) * rk * gg;
                S += h;
                const float cnt = (float)(t + 1 < w ? t + 1 : w);
                const f32x4 dl = S / cnt - h;
                u32x2 o; o.x = cvt_pk_bf16(dl[0], dl[1]); o.y = cvt_pk_bf16(dl[2], dl[3]);
                *(u32x2*)(DLT + (size_t)row * D + c) = o;
                if (t >= LP - 15) *(f32x4*)(a.out + O_POOLP + (size_t)(b * 15 + (t - (LP - 15))) * D + c) = h;
                if (t - w + 1 >= 0) { const float ro = __shfl(rs, 15 + k - w + 1); S -= *(const f32x4*)(X + (size_t)(row - w + 1) * D + c) * ro * gg; }
            }
        } else {
            float rs = 0.f; if (lane < 16) rs = rstd_of(SS, r0 + lane);
#pragma unroll 1
            for (int q = 0; q < 4; ++q) { const int bd = ((r0 - MPROMPT) >> 2) + q;
                const float* sp = stp + (size_t)bd * 15 * D + c;
                f32x4 hs[4];
#pragma unroll
                for (int i = 0; i < 4; ++i) { const float rk = __shfl(rs, 4 * q + i); hs[i] = *(const f32x4*)(X + (size_t)(r0 + 4 * q + i) * D + c) * rk * gg; }
                for (int j = 0; j < 11; ++j) *(f32x4*)(a.out + O_POOLS + (size_t)(bd * 15 + j) * D + c) = *(const f32x4*)(sp + (size_t)(j + 4) * D);
#pragma unroll
                for (int i = 0; i < 4; ++i) *(f32x4*)(a.out + O_POOLS + (size_t)(bd * 15 + 11 + i) * D + c) = hs[i];
#pragma unroll
                for (int i = 0; i < 4; ++i) {
                    f32x4 S = (f32x4){0.f, 0.f, 0.f, 0.f};
                    for (int e = 15 + i - w + 1; e <= 15 + i; ++e) { if (e < 15) S += *(const f32x4*)(sp + (size_t)e * D); else { const int hi = e - 15; S += (hi == 0 ? hs[0] : hi == 1 ? hs[1] : hi == 2 ? hs[2] : hs[3]); } }
                    const f32x4 dl = S / (float)w - hs[i];
                    u32x2 o; o.x = cvt_pk_bf16(dl[0], dl[1]); o.y = cvt_pk_bf16(dl[2], dl[3]);
                    *(u32x2*)(DLT + (size_t)(r0 + 4 * q + i) * D + c) = o;
                }
            }
        }
    }
}

__global__ void __launch_bounds__(NWAVES * 64, 2) fwd_kernel(Args args) {
    extern __shared__ __attribute__((aligned(16))) unsigned char lds_raw[];
    Frame F;
    F.lds = (LAS unsigned char*)lds_raw;
    F.tid = threadIdx.x; F.lane = F.tid & 63; F.wave = __builtin_amdgcn_readfirstlane(F.tid >> 6);
    F.G = gridDim.x; F.bid = blockIdx.x;
    volatile LAS unsigned* MISC = (volatile LAS unsigned*)(F.lds + MISC_OFF);
    for (int u = F.tid; u < (LDS_BYTES - RING_BYTES) / 4; u += NWAVES * 64) ((LAS unsigned*)(F.lds + RING_BYTES))[u] = 0u;
    __syncthreads();
    unsigned char* ws = args.ws;
    unsigned* ctl = (unsigned*)(ws + WS_CTL);
    XcdBarrier bar = xcd_barrier_post(ctl + CW_BAR, MISC + 8);
    const int G = F.G, bid = F.bid;
    RowMap R{args.in[0], args.in[1], args.in[6], args.out + O_YP, args.out + O_YS};
    float* X = (float*)(ws + WS_X);
    bf16_t* XB = (bf16_t*)args.out;
    float* SS1 = (float*)(ws + WS_SS); float* SS2 = SS1 + (size_t)MPAD * 16; float* SS3 = SS2 + (size_t)MPAD * 16;

#ifndef PHM
#define PHM 0x3ff
#endif
    if (PHM & 1) p0_prologue(F, args);
    xcd_barrier(bar);
    if (PHM & 2) { pg8::Gemm g{(const bf16_t*)(ws + WS_H0), (const bf16_t*)(ws + WS_WIN), D, D, 0}; pg8::StaticOrder S; S.init(NPANEL, DIN / 256, G, bid);
      pg8::EpiBf16 E{(bf16_t*)(ws + WS_Z), DIN};
      pg8::gemm_phase(F.lds, g, S, E); }
    xcd_barrier(bar);
    if (PHM & 4) mixer_phase(F, args);
    xcd_barrier(bar);
    if (PHM & 8) { pg8::Gemm g{(const bf16_t*)(ws + WS_MIX), (const bf16_t*)(ws + WS_WOUT), D, D, 0}; pg8::StaticOrder S; S.init(NPANEL, D / 256, G, bid);
      pg8::EpiRes<0, 0, true, true, false> E{R, X, XB, SS1, nullptr};
      pg8::gemm_phase(F.lds, g, S, E); }
    xcd_barrier(bar);
    if (PHM & 16) { pg8::Gemm g{XB, (const bf16_t*)(ws + WS_WUP0), D, D, 0}; pg8::StaticOrder S; S.init(NPANEL, FF / 256, G, bid);
      pg8::EpiHid E{(bf16_t*)(ws + WS_HID), FF, SS1};
      pg8::gemm_phase(F.lds, g, S, E); }
    xcd_barrier(bar);
    if (PHM & 32) { pg8::Gemm g{(const bf16_t*)(ws + WS_HID), (const bf16_t*)(ws + WS_WDN0), FF, FF, 0}; pg8::StaticOrder S; S.init(NPANEL, D / 256, G, bid);
      pg8::EpiRes<1, 0, false, true, false> E{R, X, XB, SS2, nullptr};
      pg8::gemm_phase(F.lds, g, S, E); }
    xcd_barrier(bar);
    if (PHM & 64) pool_phase(F, args);
    xcd_barrier(bar);
    if (PHM & 128) { pg8::Gemm g{(const bf16_t*)(ws + WS_DLT), (const bf16_t*)(ws + WS_WPOOL), D, 256, 512}; pg8::StaticOrder S; S.init(NPANEL, 4, G, bid);
      pg8::EpiRes<1, 0, true, true, true> E{R, X, XB, SS3, args.in[16]};
      pg8::gemm_phase(F.lds, g, S, E); }
    xcd_barrier(bar);
    if (PHM & 256) { pg8::Gemm g{XB, (const bf16_t*)(ws + WS_WUP1), D, D, 0}; pg8::StaticOrder S; S.init(NPANEL, FF / 256, G, bid);
      pg8::EpiHid E{(bf16_t*)(ws + WS_HID), FF, SS3};
      pg8::gemm_phase(F.lds, g, S, E); }
    xcd_barrier(bar);
    if (PHM & 512) { pg8::Gemm g{(const bf16_t*)(ws + WS_HID), (const bf16_t*)(ws + WS_WDN1), FF, FF, 0}; pg8::StaticOrder S; S.init(NPANEL, D / 256, G, bid);
      pg8::EpiRes<1, 1, false, false, false> E{R, X, XB, nullptr, nullptr};
      pg8::gemm_phase(F.lds, g, S, E); }
}

extern "C" void kernel_launch(void* const* d_in, const int* in_sizes, int n_in, void* d_out, int out_size, void* d_ws, size_t ws_size, hipStream_t stream) {
    static int grid = 0;
    if (grid == 0) {
        if (n_in != 19 || out_size != (int)O_END || ws_size < WS_END) { fprintf(stderr, "kernel_launch: unexpected shapes (n_in %d out %d ws %zu)\n", n_in, out_size, ws_size); grid = -1; return; }
        int dev = 0, cus = 0, per_cu = 0;
        if (hipGetDevice(&dev) != hipSuccess || hipDeviceGetAttribute(&cus, hipDeviceAttributeMultiprocessorCount, dev) != hipSuccess) { grid = -1; return; }
        if (hipFuncSetAttribute((const void*)fwd_kernel, hipFuncAttributeMaxDynamicSharedMemorySize, LDS_BYTES) != hipSuccess) { fprintf(stderr, "kernel_launch: hipFuncSetAttribute failed\n"); grid = -1; return; }
        if (hipOccupancyMaxActiveBlocksPerMultiprocessor(&per_cu, (const void*)fwd_kernel, NWAVES * 64, LDS_BYTES) != hipSuccess || per_cu < 1) { fprintf(stderr, "kernel_launch: occupancy query says %d blocks per CU\n", per_cu); per_cu = 1; }
        (void)hipGetLastError();
        grid = cus;
    }
    if (grid < 0) return;
    (void)hipMemsetAsync((char*)d_ws + WS_CTL, 0, CTL_ZERO_BYTES, stream);
    Args a{};
    for (int i = 0; i < 19; ++i) a.in[i] = (const float*)d_in[i];
    a.out = (float*)d_out; a.ws = (unsigned char*)d_ws;
    hipLaunchKernelGGL(fwd_kernel, dim3(grid), dim3(NWAVES * 64), LDS_BYTES, stream, a);
}
```
